# Optimizing an MI355X kernel written in HIP

```python
import jax, jax.numpy as jnp
from jax import lax
import numpy as np

D_MODEL = 1024
BATCH = 2
SEQ = 8192
DEPTH = 1

POOL_WINDOWS = (2, 4, 8, 16)
N_POOL_GROUPS = len(POOL_WINDOWS)
D_POOL = D_MODEL
POOL_GW = D_POOL // N_POOL_GROUPS
POOL_OUT_GW = D_MODEL // N_POOL_GROUPS
D_CONV = D_MODEL
CONV_K = 3
D_IN = D_POOL + 3 * D_CONV + 2 * D_MODEL
D_FF = 2816
FFN_K = 3
N_MOD = 6
EPS = 1e-6

kernel_name = "hybrid_pool_shortconv_convffn_block"


def rmsnorm(x, g):
    xf = x.astype(jnp.float32)
    y = xf * lax.rsqrt(jnp.mean(xf * xf, axis=-1, keepdims=True) + EPS)
    return (y * g.astype(jnp.float32)).astype(x.dtype)


def causal_dwconv(x, w, b):
    k = w.shape[0]
    s = x.shape[1]
    xp = jnp.pad(x, ((0, 0), (k - 1, 0), (0, 0)))
    y = b
    for i in range(k):
        y = y + w[i] * xp[:, i:i + s]
    return y


def causal_multiscale_pool(u):
    bsz, s, _ = u.shape
    ug = u.reshape(bsz, s, N_POOL_GROUPS, POOL_GW)
    cs = jnp.cumsum(ug.astype(jnp.float32), axis=1)
    cs0 = jnp.pad(cs, ((0, 0), (1, 0), (0, 0), (0, 0)))
    t1 = jnp.arange(1, s + 1, dtype=jnp.float32)
    outs = []
    for g, w in enumerate(POOL_WINDOWS):
        upper = cs0[:, 1:, g]
        lower = jnp.pad(cs0[:, :s + 1 - w, g], ((0, 0), (w - 1, 0), (0, 0)))
        cnt = jnp.minimum(t1, float(w))[None, :, None]
        outs.append((upper - lower) / cnt)
    pooled = jnp.stack(outs, axis=2).astype(u.dtype)
    return pooled - ug


def setup_inputs(seed: int = 0) -> dict:
    key = jax.random.key(seed)
    ks = jax.random.split(key, 20)
    L, D = DEPTH, D_MODEL
    nrm = lambda k, shp, fan: jax.random.normal(k, shp, jnp.float32) * (fan ** -0.5)
    gain = lambda k, n: 1.0 + 0.05 * jax.random.normal(k, (L, n), jnp.float32)
    return {
        "x": jax.random.normal(ks[0], (BATCH, SEQ, D), jnp.float32),
        "c": jax.random.normal(ks[1], (BATCH, D), jnp.float32),
        "g_pre_mix": gain(ks[2], D),
        "g_post_mix": gain(ks[3], D),
        "g_pre_ffn": gain(ks[4], D),
        "g_post_ffn": gain(ks[5], D),
        "w_ada": 0.5 * nrm(ks[6], (L, D, N_MOD * D), D),
        "b_ada": 0.01 * jax.random.normal(ks[7], (L, N_MOD * D), jnp.float32),
        "w_in": nrm(ks[8], (L, D, D_IN), D),
        "w_pool": nrm(ks[9], (L, N_POOL_GROUPS, POOL_GW, POOL_OUT_GW), POOL_GW),
        "pool_scale": gain(ks[10], D),
        "conv_w": nrm(ks[11], (L, CONV_K, D_CONV), CONV_K),
        "conv_b": 0.01 * jax.random.normal(ks[12], (L, D_CONV), jnp.float32),
        "w_bout": nrm(ks[13], (L, D_CONV, D), D_CONV),
        "w_o": nrm(ks[14], (L, D, D), D),
        "w_up": nrm(ks[15], (L, D, 2 * D_FF), D),
        "ffn_conv_w": nrm(ks[16], (L, FFN_K, 2 * D_FF), FFN_K),
        "ffn_conv_b": 0.01 * jax.random.normal(ks[17], (L, 2 * D_FF), jnp.float32),
        "w_down": nrm(ks[18], (L, D_FF, D), D_FF),
    }


def reference(x, c, g_pre_mix, g_post_mix, g_pre_ffn, g_post_ffn, w_ada, b_ada, w_in, w_pool,
              pool_scale, conv_w, conv_b, w_bout, w_o, w_up, ffn_conv_w, ffn_conv_b, w_down):
    bsz, s, d = x.shape
    for l in range(DEPTH):
        mod = c @ w_ada[l] + b_ada[l]
        sh1, sc1, gt1, sh2, sc2, gt2 = [m[:, None, :] for m in jnp.split(mod, N_MOD, axis=-1)]

        h = rmsnorm(x, g_pre_mix[l]) * (1.0 + sc1) + sh1
        proj = h @ w_in[l]
        u_pool, u_x, u_b, u_c, z_a, z_b = jnp.split(
            proj, np.cumsum([D_POOL, D_CONV, D_CONV, D_CONV, D_MODEL])[:].tolist(), axis=-1)

        pg = causal_multiscale_pool(u_pool)
        y_a = jnp.einsum('bsgc,gcd->bsgd', pg, w_pool[l]).reshape(bsz, s, d) * pool_scale[l]

        y_b = (u_b * causal_dwconv(u_c * u_x, conv_w[l], conv_b[l])) @ w_bout[l]

        merged = jax.nn.sigmoid(z_a) * y_a + jax.nn.sigmoid(z_b) * y_b
        x = x + gt1 * rmsnorm(merged @ w_o[l], g_post_mix[l])

        h = rmsnorm(x, g_pre_ffn[l]) * (1.0 + sc2) + sh2
        up = causal_dwconv(h @ w_up[l], ffn_conv_w[l], ffn_conv_b[l])
        gate, val = jnp.split(up, 2, axis=-1)
        ff = (jax.nn.gelu(gate, approximate=True) * val) @ w_down[l]
        x = x + gt2 * rmsnorm(ff, g_post_ffn[l])
    return x
```

```cpp
#include <hip/hip_runtime.h>
#include <hip/hip_cooperative_groups.h>
#include <cstdio>
#include <cstdint>
namespace cg = cooperative_groups;

namespace pg8 {
#define PG8_LAS __attribute__((address_space(3)))
typedef unsigned short bf16_t;
typedef short bf16x8 __attribute__((ext_vector_type(8)));
typedef float f32x4 __attribute__((ext_vector_type(4)));
typedef unsigned u32x4 __attribute__((ext_vector_type(4)));
constexpr int BM = 256, BK = 64, HALF = 128, HTB = HALF * BK * 2  , STAGE_BYTES = 8 * HTB, NXCD = 8, WGM = 8;

__host__ __device__ __forceinline__ int lds_byte(int r, int c) { const int st = (r >> 4) * 2 + (c >> 5), rr = r & 15, cc = c & 31, ob = rr * 64 + cc * 2; return st * 1024 + (ob ^ (((ob >> 9) & 1) << 5)); }
__host__ __device__ __forceinline__ void stage_rc(int b, int& R, int& C) { const int st = b / 1024, sb = b % 1024, swz = sb ^ (((sb >> 9) & 1) << 5); R = (st >> 1) * 16 + swz / 64; C = (st & 1) * 32 + (swz % 64) / 2; }
__host__ __device__ __forceinline__ int perm32(int rho) { const int n = rho >> 4, i = rho & 15; return 8 * (i >> 2) + 4 * n + (i & 3); }

struct Unit { int pm, pn; };
struct Gemm { const bf16_t* A; const bf16_t* Bt; int M, N, K, lda, ldb, a_pn_off; };

struct StaticOrder {
    int nM, nN, nwg, G, c;
    __host__ __device__ void init(int M, int N, int G_, int c_) { nM = M / BM; nN = N / BM; nwg = nM * nN; G = G_; c = c_; }
    __host__ __device__ bool next(int i, Unit& u) const {
        const long L = (long)i * G + c; if (L >= nwg) return false;
        int wgid = (int)L; { const int q = nwg / NXCD, r = nwg % NXCD, xcd = wgid % NXCD, off = wgid / NXCD; wgid = (xcd < r ? xcd * (q + 1) : r * (q + 1) + (xcd - r) * q) + off; }
        const int nig = WGM * nN, gid = wgid / nig, fm = gid * WGM, gsz = (nM - fm) < WGM ? (nM - fm) : WGM;
        u.pm = fm + ((wgid % nig) % gsz); u.pn = (wgid % nig) / gsz; return true;
    }
};

__device__ __forceinline__ unsigned cvt_pk_bf16(float lo, float hi) { unsigned r; asm volatile("v_cvt_pk_bf16_f32 %0, %1, %2" : "=v"(r) : "v"(lo), "v"(hi)); return r; }
__device__ __forceinline__ float bf_lo(unsigned u) { return __uint_as_float(u << 16); }
__device__ __forceinline__ float bf_hi(unsigned u) { return __uint_as_float(u & 0xffff0000u); }
__device__ __forceinline__ float sigmoidf_(float v) { return 1.0f / (1.0f + __expf(-v)); }

struct EpiStore {
    static constexpr bool PERM = true;
    bf16_t* O; int ldc; int split_cols; size_t split_stride; int sig_from;
    __device__ __forceinline__ void operator()(const f32x4 (&acc)[2][2][4][2], const Unit& u, int wr, int wc, int fr, int fq) const {
        const int row0 = u.pm * BM + wr * 64 + fr; int colt = u.pn * BM; bf16_t* base = O; bool sig = false;
        if (split_cols) { const int t = colt / split_cols; base += (size_t)t * split_stride; colt -= t * split_cols; sig = t >= sig_from; }
        const int col0 = colt + wc * 32 + 8 * fq;
#pragma unroll
        for (int ai = 0; ai < 2; ++ai)
#pragma unroll
            for (int m = 0; m < 4; ++m) { bf16_t* rowp = base + (size_t)(row0 + ai * HALF + m * 16) * ldc + col0;
#pragma unroll
                for (int bj = 0; bj < 2; ++bj) { f32x4 v0 = acc[ai][bj][m][0], v1 = acc[ai][bj][m][1];
                    if (sig) {
#pragma unroll
                        for (int e = 0; e < 4; ++e) { v0[e] = sigmoidf_(v0[e]); v1[e] = sigmoidf_(v1[e]); } }
                    u32x4 w; w.x = cvt_pk_bf16(v0[0], v0[1]); w.y = cvt_pk_bf16(v0[2], v0[3]); w.z = cvt_pk_bf16(v1[0], v1[1]); w.w = cvt_pk_bf16(v1[2], v1[3]);
                    *(u32x4*)(rowp + bj * HALF) = w; } }
    }
};
struct EpiMerge {
    static constexpr bool PERM = true;
    bf16_t* O; const bf16_t* YA; const bf16_t* SA; const bf16_t* SB; const float* ps; int ldc;
    __device__ __forceinline__ void operator()(const f32x4 (&acc)[2][2][4][2], const Unit& u, int wr, int wc, int fr, int fq) const {
        const int row0 = u.pm * BM + wr * 64 + fr; const int col0 = u.pn * BM + wc * 32 + 8 * fq;
#pragma unroll
        for (int bj = 0; bj < 2; ++bj) {
            const f32x4 p0 = *(const f32x4*)(ps + col0 + bj * HALF), p1 = *(const f32x4*)(ps + col0 + bj * HALF + 4);
#pragma unroll
            for (int ai = 0; ai < 2; ++ai)
#pragma unroll
                for (int m = 0; m < 4; ++m) { const size_t off = (size_t)(row0 + ai * HALF + m * 16) * ldc + col0 + bj * HALF;
                    const u32x4 ya = *(const u32x4*)(YA + off), sa = *(const u32x4*)(SA + off), sb = *(const u32x4*)(SB + off);
                    const f32x4 v0 = acc[ai][bj][m][0], v1 = acc[ai][bj][m][1];
                    float r[8];
                    r[0] = bf_lo(sa.x) * bf_lo(ya.x) * p0[0] + bf_lo(sb.x) * v0[0]; r[1] = bf_hi(sa.x) * bf_hi(ya.x) * p0[1] + bf_hi(sb.x) * v0[1];
                    r[2] = bf_lo(sa.y) * bf_lo(ya.y) * p0[2] + bf_lo(sb.y) * v0[2]; r[3] = bf_hi(sa.y) * bf_hi(ya.y) * p0[3] + bf_hi(sb.y) * v0[3];
                    r[4] = bf_lo(sa.z) * bf_lo(ya.z) * p1[0] + bf_lo(sb.z) * v1[0]; r[5] = bf_hi(sa.z) * bf_hi(ya.z) * p1[1] + bf_hi(sb.z) * v1[1];
                    r[6] = bf_lo(sa.w) * bf_lo(ya.w) * p1[2] + bf_lo(sb.w) * v1[2]; r[7] = bf_hi(sa.w) * bf_hi(ya.w) * p1[3] + bf_hi(sb.w) * v1[3];
                    u32x4 w; w.x = cvt_pk_bf16(r[0], r[1]); w.y = cvt_pk_bf16(r[2], r[3]); w.z = cvt_pk_bf16(r[4], r[5]); w.w = cvt_pk_bf16(r[6], r[7]);
                    *(u32x4*)(O + off) = w; }
        }
    }
};

template <class Epi, class Sched, bool ALIGN_EPI = false>
__device__ __forceinline__ void gemm_phase(PG8_LAS unsigned char* lds, const Gemm g, const Sched& S, const Epi& E) {
    const int tid = threadIdx.x, wid = __builtin_amdgcn_readfirstlane(tid >> 6), lane = tid & 63, wr = wid >> 2, wc = wid & 3, fr = lane & 15, fq = lane >> 4;
    const int K = g.K, nt = K / BK;
    unsigned voffA[2], voffB[2];
#pragma unroll
    for (int i = 0; i < 2; ++i) { int R, C; stage_rc(tid * 16 + i * 8192, R, C); const int Rb = Epi::PERM ? ((R & ~31) + perm32(R & 31)) : R;
        voffA[i] = (unsigned)(R * g.lda + C) * 2u; voffB[i] = (unsigned)(Rb * g.ldb + C) * 2u; }
    const size_t kstep = (size_t)(BK * 2);
    const size_t hstepA = (size_t)HALF * g.lda * 2, hstepB = (size_t)HALF * g.ldb * 2;
    const size_t tstepA = 2 * hstepA, tstepB = 2 * hstepB;
    const size_t pnoffA = (size_t)g.a_pn_off * 2;
    const unsigned ldsw = (unsigned)wid * 1024u;
    const int aoff = lds_byte(wr * 64 + fr, fq * 8), boff = lds_byte(wc * 32 + fr, fq * 8);
#define PG8_SA(b, h) (((b) * 2 + (h)) * HTB)
#define PG8_SB(b, h) ((4 + (b) * 2 + (h)) * HTB)
#define PG8_STAGE(bufoff, gbase, voff) do { _Pragma("unroll") for (int _i = 0; _i < 2; ++_i) \
        __builtin_amdgcn_global_load_lds((const unsigned*)((const char*)(gbase) + (voff)[_i]), (PG8_LAS unsigned*)(lds + (bufoff) + ldsw + _i * 8192), 16, 0, 0); } while (0)
#define PG8_LDA(dst, b, h) do { _Pragma("unroll") for (int m = 0; m < 4; ++m) _Pragma("unroll") for (int k = 0; k < 2; ++k) dst[m][k] = *(const PG8_LAS bf16x8*)(lds + PG8_SA(b, h) + aoff + m * 2048 + k * 1024); } while (0)
#define PG8_LDB(dst, b, h) do { _Pragma("unroll") for (int n = 0; n < 2; ++n) _Pragma("unroll") for (int k = 0; k < 2; ++k) dst[n][k] = *(const PG8_LAS bf16x8*)(lds + PG8_SB(b, h) + boff + n * 2048 + k * 1024); } while (0)
#define PG8_MMA(ai, bj, At, Bt) do { __builtin_amdgcn_s_setprio(1); _Pragma("unroll") for (int m = 0; m < 4; ++m) _Pragma("unroll") for (int n = 0; n < 2; ++n) _Pragma("unroll") for (int k = 0; k < 2; ++k) \
        acc[ai][bj][m][n] = __builtin_amdgcn_mfma_f32_16x16x32_bf16(Bt[n][k], At[m][k], acc[ai][bj][m][n], 0, 0, 0); __builtin_amdgcn_s_setprio(0); } while (0)
#define PG8_WAIT_V(n) asm volatile("s_waitcnt vmcnt(" #n ")" ::: "memory")
#define PG8_WAIT_L(n) asm volatile("s_waitcnt lgkmcnt(" #n ")" ::: "memory")
#define PG8_BAR __builtin_amdgcn_s_barrier()
#define PG8_SCHED __builtin_amdgcn_sched_barrier(0)
    Unit cur, nxt; int ui = 0;
    if (!S.next(0, cur)) return;
    f32x4 acc[2][2][4][2];
#pragma unroll
    for (int a = 0; a < 2; ++a)
#pragma unroll
        for (int b = 0; b < 2; ++b)
#pragma unroll
            for (int m = 0; m < 4; ++m)
#pragma unroll
                for (int n = 0; n < 2; ++n) acc[a][b][m][n] = (f32x4){0.f, 0.f, 0.f, 0.f};
    bf16x8 At[4][2], B0[2][2], B1[2][2];
    const char* cA = (const char*)g.A + (size_t)cur.pm * tstepA + (size_t)cur.pn * pnoffA; const char* cB = (const char*)g.Bt + (size_t)cur.pn * tstepB;
    PG8_STAGE(PG8_SB(0, 0), cB, voffB); PG8_STAGE(PG8_SB(0, 1), cB + hstepB, voffB); PG8_STAGE(PG8_SA(0, 0), cA, voffA); PG8_STAGE(PG8_SA(0, 1), cA + hstepA, voffA);
    if (wr == 1) PG8_BAR;
    PG8_WAIT_V(2); PG8_BAR;
    PG8_STAGE(PG8_SB(1, 0), cB + kstep, voffB); PG8_STAGE(PG8_SA(1, 0), cA + kstep, voffA); PG8_STAGE(PG8_SB(1, 1), cB + hstepB + kstep, voffB);
    PG8_WAIT_V(6); PG8_BAR;
    for (;;) {
        const bool has_next = S.next(ui + 1, nxt);
        const char* nA = has_next ? (const char*)g.A + (size_t)nxt.pm * tstepA + (size_t)nxt.pn * pnoffA : cA; const char* nB = has_next ? (const char*)g.Bt + (size_t)nxt.pn * tstepB : cB;
        for (int t = 0; t < nt; t += 2) {
            const bool last = (t == nt - 2);
            const char* a1 = cA + (size_t)(t + 1) * kstep;
            const char* a2 = last ? nA : cA + (size_t)(t + 2) * kstep; const char* b2 = last ? nB : cB + (size_t)(t + 2) * kstep;
            const char* a3 = a2 + kstep; const char* b3 = b2 + kstep;
            PG8_LDB(B0, 0, 0); PG8_LDB(B1, 0, 1); PG8_SCHED; PG8_LDA(At, 0, 0); PG8_STAGE(PG8_SA(1, 1), a1 + hstepA, voffA);
            PG8_WAIT_V(8); PG8_WAIT_L(0); PG8_BAR; PG8_MMA(0, 0, At, B0); PG8_MMA(0, 1, At, B1); PG8_BAR; PG8_SCHED;
            PG8_LDA(At, 0, 1); PG8_STAGE(PG8_SB(0, 0), b2, voffB); PG8_STAGE(PG8_SB(0, 1), b2 + hstepB, voffB); PG8_STAGE(PG8_SA(0, 0), a2, voffA);
            PG8_WAIT_V(8); PG8_WAIT_L(0); PG8_BAR; PG8_MMA(1, 0, At, B0); PG8_MMA(1, 1, At, B1); PG8_BAR; PG8_SCHED;
            PG8_LDB(B0, 1, 0); PG8_LDB(B1, 1, 1); PG8_SCHED; PG8_LDA(At, 1, 0); PG8_STAGE(PG8_SA(0, 1), a2 + hstepA, voffA);
            PG8_WAIT_V(8); PG8_WAIT_L(0); PG8_BAR; PG8_MMA(0, 0, At, B0); PG8_MMA(0, 1, At, B1); PG8_BAR; PG8_SCHED;
            PG8_LDA(At, 1, 1); PG8_STAGE(PG8_SB(1, 0), b3, voffB); PG8_STAGE(PG8_SB(1, 1), b3 + hstepB, voffB); PG8_STAGE(PG8_SA(1, 0), a3, voffA);
            PG8_WAIT_V(8); PG8_WAIT_L(0); PG8_BAR; PG8_MMA(1, 0, At, B0); PG8_MMA(1, 1, At, B1); PG8_BAR; PG8_SCHED;
        }
        if constexpr (ALIGN_EPI) { if (wr == 0) PG8_BAR; }
        E(acc, cur, wr, wc, fr, fq);
        if (!has_next) break;
#pragma unroll
        for (int a = 0; a < 2; ++a)
#pragma unroll
            for (int b = 0; b < 2; ++b)
#pragma unroll
                for (int m = 0; m < 4; ++m)
#pragma unroll
                    for (int n = 0; n < 2; ++n) acc[a][b][m][n] = (f32x4){0.f, 0.f, 0.f, 0.f};
        cur = nxt; cA = nA; cB = nB; ++ui;
        if constexpr (ALIGN_EPI) { if (wr == 1) PG8_BAR; }
    }
    PG8_WAIT_V(0);
    if constexpr (!ALIGN_EPI) { if (wr == 0) PG8_BAR; }
    PG8_BAR;
#undef PG8_SA
#undef PG8_SB
#undef PG8_STAGE
#undef PG8_LDA
#undef PG8_LDB
#undef PG8_MMA
#undef PG8_WAIT_V
#undef PG8_WAIT_L
#undef PG8_BAR
#undef PG8_SCHED
}
}

constexpr int NWAVES = 8, NTHR = NWAVES * 64;
constexpr int BATCH = 2, SEQ = 8192, D = 1024, M = BATCH * SEQ, DIN = 6 * D, DFF = 2816, NUP = 2 * DFF, NMOD = 6 * D;
constexpr float EPS = 1e-6f;
constexpr size_t MiB = 1u << 20;
constexpr size_t WS_MOD = 0, CTL_ZERO_BYTES = 65536;
constexpr size_t WS_WIN = 1 * MiB, WS_WPOOL = 13 * MiB, WS_WBOUT = 14 * MiB, WS_WO = 16 * MiB, WS_WUP = 18 * MiB, WS_WDOWN = 29 * MiB;
constexpr size_t WS_SLOT0 = 35 * MiB, SLOT_BYTES = 32 * MiB;
constexpr size_t WS_UPB = WS_SLOT0;
constexpr size_t WS_FFA = WS_SLOT0 + 4 * SLOT_BYTES;
constexpr size_t WS_END = 256 * MiB;
static_assert(WS_FFA + (size_t)M * DFF * 2 <= WS_END && WS_UPB + (size_t)SEQ * NUP * 2 <= WS_SLOT0 + 3 * SLOT_BYTES, "ws map");
constexpr int RING_BYTES = 131072, LDS_BYTES = 147456;

#define LAS __attribute__((address_space(3)))
typedef unsigned short bf16;
typedef unsigned v4u __attribute__((ext_vector_type(4)));
typedef unsigned v2u __attribute__((ext_vector_type(2)));
typedef float f32x4 __attribute__((ext_vector_type(4)));
#define LDS_WAIT() asm volatile("s_waitcnt lgkmcnt(0)" ::: "memory")
__device__ __forceinline__ unsigned f2bf(float f) { unsigned u = __builtin_bit_cast(unsigned, f); return (u + 0x7fffu + ((u >> 16) & 1u)) >> 16; }
__device__ __forceinline__ unsigned pk2(float lo, float hi) { return f2bf(lo) | (f2bf(hi) << 16); }
__device__ __forceinline__ float blo(unsigned u) { return __uint_as_float(u << 16); }
__device__ __forceinline__ float bhi(unsigned u) { return __uint_as_float(u & 0xffff0000u); }
__device__ __forceinline__ void unpack8(const v4u u, float (&f)[8]) { f[0] = blo(u.x); f[1] = bhi(u.x); f[2] = blo(u.y); f[3] = bhi(u.y); f[4] = blo(u.z); f[5] = bhi(u.z); f[6] = blo(u.w); f[7] = bhi(u.w); }
__device__ __forceinline__ v4u pack8(const float (&f)[8]) { v4u o; o.x = pk2(f[0], f[1]); o.y = pk2(f[2], f[3]); o.z = pk2(f[4], f[5]); o.w = pk2(f[6], f[7]); return o; }
__device__ __forceinline__ float wave_sum(float v) {
#pragma unroll
    for (int o = 1; o < 64; o <<= 1) v += __shfl_xor(v, o);
    return v;
}
__device__ __forceinline__ float gelu_tanh(float v) { const float u = 0.7978845608028654f * (v + 0.044715f * v * v * v); return v / (1.0f + __expf(-2.0f * u)); }

__device__ __forceinline__ void p0_transpose_item(const float* W, int K, int N, bf16* WT, LAS float* scr, int item, int lane) {
    const int nblk = N / 32, kb = item / nblk, nb = item % nblk, k0 = 64 * kb, n0 = 32 * nb;
#pragma unroll 8
    for (int i = 0; i < 32; ++i) { const int kk = 2 * i + (lane >> 5); scr[kk * 33 + (lane & 31)] = W[(size_t)(k0 + kk) * N + n0 + (lane & 31)]; }
    LDS_WAIT(); asm volatile("" ::: "memory");
    const int c = lane & 7;
#pragma unroll
    for (int j = 0; j < 4; ++j) { const int n = (lane >> 3) + 8 * j; const LAS float* s = scr + (8 * c) * 33 + n;
        v4u o; o.x = pk2(s[0 * 33], s[1 * 33]); o.y = pk2(s[2 * 33], s[3 * 33]); o.z = pk2(s[4 * 33], s[5 * 33]); o.w = pk2(s[6 * 33], s[7 * 33]);
        *(v4u*)(WT + (size_t)(n0 + n) * K + k0 + 8 * c) = o; }
    LDS_WAIT(); asm volatile("" ::: "memory");
}

struct Args { const float* in[19]; float* out; unsigned char* ws; };

__global__ void __launch_bounds__(NTHR, 2) fwd_megakernel(Args args) {
    extern __shared__ __attribute__((aligned(16))) unsigned char lds_raw[];
    cg::grid_group grid = cg::this_grid();
    LAS unsigned char* lds = (LAS unsigned char*)lds_raw;
    const int tid = threadIdx.x, lane = tid & 63, wave = __builtin_amdgcn_readfirstlane(tid >> 6);
    const int G = gridDim.x, bx = blockIdx.x;
    const int gw = bx * NWAVES + wave, NGW = G * NWAVES;
    unsigned char* ws = args.ws;
    const float* x = args.in[0]; const float* cvec = args.in[1];
    const float *g_pre_mix = args.in[2], *g_post_mix = args.in[3], *g_pre_ffn = args.in[4], *g_post_ffn = args.in[5];
    const float *w_ada = args.in[6], *b_ada = args.in[7], *w_in = args.in[8], *w_pool = args.in[9], *pool_scale = args.in[10];
    const float *conv_w = args.in[11], *conv_b = args.in[12], *w_bout = args.in[13], *w_o = args.in[14], *w_up = args.in[15];
    const float *ffn_conv_w = args.in[16], *ffn_conv_b = args.in[17], *w_down = args.in[18];
    float* out = args.out;
    float* mod = (float*)(ws + WS_MOD);
    bf16 *WT_IN = (bf16*)(ws + WS_WIN), *WT_POOL = (bf16*)(ws + WS_WPOOL), *WT_BOUT = (bf16*)(ws + WS_WBOUT), *WT_O = (bf16*)(ws + WS_WO), *WT_UP = (bf16*)(ws + WS_WUP), *WT_DOWN = (bf16*)(ws + WS_WDOWN);
    bf16* SLOT[6];
#pragma unroll
    for (int i = 0; i < 6; ++i) SLOT[i] = (bf16*)(ws + WS_SLOT0 + i * SLOT_BYTES);
    bf16* H1 = (bf16*)out;
    bf16* BMIX = (bf16*)out; bf16* POOLED = (bf16*)out + (size_t)M * D;
    bf16* YA = SLOT[0]; bf16* MERGED = SLOT[1]; bf16* OB = SLOT[2]; bf16* H2 = SLOT[3];
    bf16* UPB = (bf16*)(ws + WS_UPB); bf16* FFA = (bf16*)(ws + WS_FFA); bf16* FFO = SLOT[0];

    {
        LAS float* scr = (LAS float*)(lds + wave * 16384);
        constexpr int I_IN = (D / 64) * (DIN / 32), I_POOL = (256 / 64) * (256 / 32), I_SQ = (D / 64) * (D / 32), I_UP = (D / 64) * (NUP / 32), I_DOWN = (DFF / 64) * (D / 32);
        constexpr int NITEMS = I_IN + 4 * I_POOL + 2 * I_SQ + I_UP + I_DOWN;
        for (int it = gw; it < NITEMS; it += NGW) {
            int r = it;
            if (r < I_IN) { p0_transpose_item(w_in, D, DIN, WT_IN, scr, r, lane); continue; } r -= I_IN;
            if (r < 4 * I_POOL) { const int gq = r / I_POOL; p0_transpose_item(w_pool + gq * 65536, 256, 256, WT_POOL + gq * 65536, scr, r % I_POOL, lane); continue; } r -= 4 * I_POOL;
            if (r < I_SQ) { p0_transpose_item(w_bout, D, D, WT_BOUT, scr, r, lane); continue; } r -= I_SQ;
            if (r < I_SQ) { p0_transpose_item(w_o, D, D, WT_O, scr, r, lane); continue; } r -= I_SQ;
            if (r < I_UP) { p0_transpose_item(w_up, D, NUP, WT_UP, scr, r, lane); continue; } r -= I_UP;
            p0_transpose_item(w_down, DFF, D, WT_DOWN, scr, r, lane);
        }
        for (int it = gw; it < 24 * 32; it += NGW) {
            const int cgp = it % 24, ks = it / 24, n0 = cgp * 256 + lane * 4, k0 = ks * 32;
            f32x4 a0 = (f32x4){0.f, 0.f, 0.f, 0.f}, a1 = a0;
            if (ks == 0) { a0 = *(const f32x4*)(b_ada + n0); a1 = a0; }
#pragma unroll 8
            for (int k = 0; k < 32; ++k) { const f32x4 w = *(const f32x4*)(w_ada + (size_t)(k0 + k) * NMOD + n0); const float c0 = cvec[k0 + k], c1 = cvec[D + k0 + k]; a0 += w * c0; a1 += w * c1; }
#pragma unroll
            for (int e = 0; e < 4; ++e) { atomicAdd(mod + n0 + e, a0[e]); atomicAdd(mod + NMOD + n0 + e, a1[e]); }
        }
    }
    grid.sync();

    for (int m = gw; m < M; m += NGW) {
        const int b = m >> 13; const float* mb = mod + b * NMOD;
        const f32x4* xr = (const f32x4*)(x + (size_t)m * D) + lane;
        f32x4 v[4]; float s = 0.f;
#pragma unroll
        for (int j = 0; j < 4; ++j) { v[j] = xr[64 * j]; s += (v[j].x * v[j].x + v[j].y * v[j].y) + (v[j].z * v[j].z + v[j].w * v[j].w); }
        const float rstd = rsqrtf(wave_sum(s) * (1.f / D) + EPS);
        unsigned long long* o8 = (unsigned long long*)(H1 + (size_t)m * D) + lane;
#pragma unroll
        for (int j = 0; j < 4; ++j) { const int col = 4 * lane + 256 * j;
            const f32x4 gg = *(const f32x4*)(g_pre_mix + col), sh = *(const f32x4*)(mb + col), sc = *(const f32x4*)(mb + D + col);
            const f32x4 h = v[j] * rstd * gg * (sc + 1.0f) + sh;
            o8[64 * j] = (unsigned long long)pk2(h.x, h.y) | ((unsigned long long)pk2(h.z, h.w) << 32); }
    }
    grid.sync();

    {
        pg8::Gemm g{H1, WT_IN, M, DIN, D, D, D, 0}; pg8::StaticOrder S; S.init(M, DIN, G, bx);
        pg8::EpiStore E{SLOT[0], D, D, (size_t)SLOT_BYTES / 2, 4};
        pg8::gemm_phase<pg8::EpiStore, pg8::StaticOrder, true>(lds, g, S, E);
    }
    grid.sync();

    for (int ch = bx; ch < M / 64; ch += G) {
        const int co = tid & 127, rs = tid >> 7, c0 = co * 8;
        const int row0 = ch * 64 + rs * 16, t0 = row0 & (SEQ - 1);
        const bf16 *UPp = SLOT[0], *UX = SLOT[1], *UB = SLOT[2], *UC = SLOT[3];
        float w0[8], w1[8], w2[8], cb[8];
#pragma unroll
        for (int e = 0; e < 8; ++e) { w0[e] = conv_w[c0 + e]; w1[e] = conv_w[D + c0 + e]; w2[e] = conv_w[2 * D + c0 + e]; cb[e] = conv_b[c0 + e]; }
        float p2[8], p1[8];
#pragma unroll
        for (int e = 0; e < 8; ++e) { p2[e] = 0.f; p1[e] = 0.f; }
        if (t0 >= 2) { float a[8], b[8]; unpack8(*(const v4u*)(UC + (size_t)(row0 - 2) * D + c0), a); unpack8(*(const v4u*)(UX + (size_t)(row0 - 2) * D + c0), b);
#pragma unroll
            for (int e = 0; e < 8; ++e) p2[e] = a[e] * b[e]; }
        if (t0 >= 1) { float a[8], b[8]; unpack8(*(const v4u*)(UC + (size_t)(row0 - 1) * D + c0), a); unpack8(*(const v4u*)(UX + (size_t)(row0 - 1) * D + c0), b);
#pragma unroll
            for (int e = 0; e < 8; ++e) p1[e] = a[e] * b[e]; }
        const int win = 2 << (co >> 5);
        float sum[8];
#pragma unroll
        for (int e = 0; e < 8; ++e) sum[e] = 0.f;
        for (int j = 1; j < win; ++j) { if (t0 - j >= 0) { float a[8]; unpack8(*(const v4u*)(UPp + (size_t)(row0 - j) * D + c0), a);
#pragma unroll
            for (int e = 0; e < 8; ++e) sum[e] += a[e]; } }
#pragma unroll 2
        for (int i = 0; i < 16; ++i) {
            const size_t off = (size_t)(row0 + i) * D + c0; const int t = t0 + i;
            float ux[8], uc[8], ub[8], up[8], r[8];
            unpack8(*(const v4u*)(UX + off), ux); unpack8(*(const v4u*)(UC + off), uc); unpack8(*(const v4u*)(UB + off), ub); unpack8(*(const v4u*)(UPp + off), up);
#pragma unroll
            for (int e = 0; e < 8; ++e) { const float cur = uc[e] * ux[e]; r[e] = ub[e] * (cb[e] + w0[e] * p2[e] + w1[e] * p1[e] + w2[e] * cur); p2[e] = p1[e]; p1[e] = cur; }
            *(v4u*)(BMIX + off) = pack8(r);
            const float inv = 1.0f / (float)((t + 1) < win ? (t + 1) : win);
#pragma unroll
            for (int e = 0; e < 8; ++e) { sum[e] += up[e]; r[e] = sum[e] * inv - up[e]; }
            *(v4u*)(POOLED + off) = pack8(r);
            if (t - win + 1 >= 0) { float a[8]; unpack8(*(const v4u*)(UPp + (size_t)(row0 + i - win + 1) * D + c0), a);
#pragma unroll
                for (int e = 0; e < 8; ++e) sum[e] -= a[e]; }
        }
    }
    grid.sync();

    {
        pg8::Gemm g{POOLED, WT_POOL, M, D, 256, D, 256, 256}; pg8::StaticOrder S; S.init(M, D, G, bx);
        pg8::EpiStore E{YA, D, 0, 0, 0};
        pg8::gemm_phase<pg8::EpiStore, pg8::StaticOrder, true>(lds, g, S, E);
    }
    __threadfence(); __syncthreads();
    {
        pg8::Gemm g{BMIX, WT_BOUT, M, D, D, D, D, 0}; pg8::StaticOrder S; S.init(M, D, G, bx);
        pg8::EpiMerge E{MERGED, YA, SLOT[4], SLOT[5], pool_scale, D};
        pg8::gemm_phase<pg8::EpiMerge, pg8::StaticOrder, true>(lds, g, S, E);
    }
    grid.sync();

    {
        pg8::Gemm g{MERGED, WT_O, M, D, D, D, D, 0}; pg8::StaticOrder S; S.init(M, D, G, bx);
        pg8::EpiStore E{OB, D, 0, 0, 0};
        pg8::gemm_phase<pg8::EpiStore, pg8::StaticOrder, true>(lds, g, S, E);
    }
    grid.sync();

    for (int m = gw; m < M; m += NGW) {
        const int b = m >> 13; const float* mb = mod + b * NMOD;
        const v2u* orow = (const v2u*)(OB + (size_t)m * D) + lane;
        f32x4 o[4]; float s = 0.f;
#pragma unroll
        for (int j = 0; j < 4; ++j) { const v2u u = orow[64 * j]; o[j] = (f32x4){blo(u.x), bhi(u.x), blo(u.y), bhi(u.y)}; s += (o[j].x * o[j].x + o[j].y * o[j].y) + (o[j].z * o[j].z + o[j].w * o[j].w); }
        const float rstd = rsqrtf(wave_sum(s) * (1.f / D) + EPS);
        const f32x4* xr = (const f32x4*)(x + (size_t)m * D) + lane; f32x4* outr = (f32x4*)(out + (size_t)m * D) + lane;
        float s2 = 0.f;
#pragma unroll
        for (int j = 0; j < 4; ++j) { const int col = 4 * lane + 256 * j;
            const f32x4 gg = *(const f32x4*)(g_post_mix + col), gt = *(const f32x4*)(mb + 2 * D + col);
            o[j] = xr[64 * j] + gt * (o[j] * rstd * gg); outr[64 * j] = o[j];
            s2 += (o[j].x * o[j].x + o[j].y * o[j].y) + (o[j].z * o[j].z + o[j].w * o[j].w); }
        const float rstd2 = rsqrtf(wave_sum(s2) * (1.f / D) + EPS);
        unsigned long long* o8 = (unsigned long long*)(H2 + (size_t)m * D) + lane;
#pragma unroll
        for (int j = 0; j < 4; ++j) { const int col = 4 * lane + 256 * j;
            const f32x4 gg = *(const f32x4*)(g_pre_ffn + col), sh = *(const f32x4*)(mb + 3 * D + col), sc = *(const f32x4*)(mb + 4 * D + col);
            const f32x4 h = o[j] * rstd2 * gg * (sc + 1.0f) + sh;
            o8[64 * j] = (unsigned long long)pk2(h.x, h.y) | ((unsigned long long)pk2(h.z, h.w) << 32); }
    }
    grid.sync();

    for (int b = 0; b < BATCH; ++b) {
        {
            pg8::Gemm g{H2 + (size_t)b * SEQ * D, WT_UP, SEQ, NUP, D, D, D, 0}; pg8::StaticOrder S; S.init(SEQ, NUP, G, bx);
            pg8::EpiStore E{UPB, NUP, 0, 0, 0};
            pg8::gemm_phase<pg8::EpiStore, pg8::StaticOrder, true>(lds, g, S, E);
        }
        grid.sync();
        {
            constexpr int NOCT = DFF / 8, NITEM = (SEQ / 16) * NOCT;
            for (int it = bx * NTHR + tid; it < NITEM; it += G * NTHR) {
                const int oc = it % NOCT, rc = it / NOCT, c0 = oc * 8, t0 = rc * 16;
                float gw0[8], gw1[8], gw2[8], gb[8], vw0[8], vw1[8], vw2[8], vb[8];
#pragma unroll
                for (int e = 0; e < 8; ++e) { gw0[e] = ffn_conv_w[c0 + e]; gw1[e] = ffn_conv_w[NUP + c0 + e]; gw2[e] = ffn_conv_w[2 * NUP + c0 + e]; gb[e] = ffn_conv_b[c0 + e];
                    vw0[e] = ffn_conv_w[DFF + c0 + e]; vw1[e] = ffn_conv_w[NUP + DFF + c0 + e]; vw2[e] = ffn_conv_w[2 * NUP + DFF + c0 + e]; vb[e] = ffn_conv_b[DFF + c0 + e]; }
                float g2[8], g1[8], v2[8], v1[8];
#pragma unroll
                for (int e = 0; e < 8; ++e) { g2[e] = 0.f; g1[e] = 0.f; v2[e] = 0.f; v1[e] = 0.f; }
                if (t0 >= 2) { unpack8(*(const v4u*)(UPB + (size_t)(t0 - 2) * NUP + c0), g2); unpack8(*(const v4u*)(UPB + (size_t)(t0 - 2) * NUP + DFF + c0), v2);
                               unpack8(*(const v4u*)(UPB + (size_t)(t0 - 1) * NUP + c0), g1); unpack8(*(const v4u*)(UPB + (size_t)(t0 - 1) * NUP + DFF + c0), v1); }
#pragma unroll 2
                for (int i = 0; i < 16; ++i) {
                    const int t = t0 + i; float gc[8], vc[8], r[8];
                    unpack8(*(const v4u*)(UPB + (size_t)t * NUP + c0), gc); unpack8(*(const v4u*)(UPB + (size_t)t * NUP + DFF + c0), vc);
#pragma unroll
                    for (int e = 0; e < 8; ++e) { const float cgv = gb[e] + gw0[e] * g2[e] + gw1[e] * g1[e] + gw2[e] * gc[e]; const float cvv = vb[e] + vw0[e] * v2[e] + vw1[e] * v1[e] + vw2[e] * vc[e];
                        r[e] = gelu_tanh(cgv) * cvv; g2[e] = g1[e]; g1[e] = gc[e]; v2[e] = v1[e]; v1[e] = vc[e]; }
                    *(v4u*)(FFA + (size_t)(b * SEQ + t) * DFF + c0) = pack8(r);
                }
            }
        }
        grid.sync();
    }

    {
        pg8::Gemm g{FFA, WT_DOWN, M, D, DFF, DFF, DFF, 0}; pg8::StaticOrder S; S.init(M, D, G, bx);
        pg8::EpiStore E{FFO, D, 0, 0, 0};
        pg8::gemm_phase<pg8::EpiStore, pg8::StaticOrder, true>(lds, g, S, E);
    }
    grid.sync();

    for (int m = gw; m < M; m += NGW) {
        const int b = m >> 13; const float* mb = mod + b * NMOD;
        const v2u* orow = (const v2u*)(FFO + (size_t)m * D) + lane;
        f32x4 o[4]; float s = 0.f;
#pragma unroll
        for (int j = 0; j < 4; ++j) { const v2u u = orow[64 * j]; o[j] = (f32x4){blo(u.x), bhi(u.x), blo(u.y), bhi(u.y)}; s += (o[j].x * o[j].x + o[j].y * o[j].y) + (o[j].z * o[j].z + o[j].w * o[j].w); }
        const float rstd = rsqrtf(wave_sum(s) * (1.f / D) + EPS);
        f32x4* outr = (f32x4*)(out + (size_t)m * D) + lane;
#pragma unroll
        for (int j = 0; j < 4; ++j) { const int col = 4 * lane + 256 * j;
            const f32x4 gg = *(const f32x4*)(g_post_ffn + col), gt = *(const f32x4*)(mb + 5 * D + col);
            outr[64 * j] = outr[64 * j] + gt * (o[j] * rstd * gg); }
    }
}

extern "C" void kernel_launch(void* const* d_in, const int* in_sizes, int n_in, void* d_out, int out_size, void* d_ws, size_t ws_size, hipStream_t stream) {
    static int grid = 0;
    if (grid == 0) {
        if (n_in != 19 || out_size != M * D || ws_size < WS_END) { fprintf(stderr, "kernel_launch: unexpected shapes (n_in %d out %d ws %zu)\n", n_in, out_size, ws_size); grid = -1; return; }
        int dev = 0, cus = 0, per_cu = 0;
        hipGetDevice(&dev); hipDeviceGetAttribute(&cus, hipDeviceAttributeMultiprocessorCount, dev);
        if (hipFuncSetAttribute((const void*)fwd_megakernel, hipFuncAttributeMaxDynamicSharedMemorySize, LDS_BYTES) != hipSuccess) { fprintf(stderr, "kernel_launch: hipFuncSetAttribute failed\n"); grid = -1; return; }
        if (hipOccupancyMaxActiveBlocksPerMultiprocessor(&per_cu, (const void*)fwd_megakernel, NTHR, LDS_BYTES) != hipSuccess || per_cu < 1) { fprintf(stderr, "kernel_launch: occupancy query failed (%d)\n", per_cu); (void)hipGetLastError(); per_cu = 1; }
        grid = cus * (per_cu > 1 ? 1 : per_cu);
        fprintf(stderr, "kernel_launch: cus %d per_cu %d grid %d\n", cus, per_cu, grid);
    }
    if (grid < 0) return;
    hipMemsetAsync((char*)d_ws + WS_MOD, 0, CTL_ZERO_BYTES, stream);
    Args a{};
    for (int i = 0; i < 19; ++i) a.in[i] = (const float*)d_in[i];
    a.out = (float*)d_out; a.ws = (unsigned char*)d_ws;
    void* params[] = {&a};
    hipError_t e = hipLaunchCooperativeKernel((const void*)fwd_megakernel, dim3(grid), dim3(NTHR), params, LDS_BYTES, stream);
    if (e != hipSuccess) fprintf(stderr, "cooperative launch failed: %s (grid %d)\n", hipGetErrorString(e), grid);
}
```

```cpp
#include <hip/hip_runtime.h>
#include <hip/hip_cooperative_groups.h>
#include <cstdio>
#include <cstdint>
namespace cg = cooperative_groups;

namespace pg8 {
#define PG8_LAS __attribute__((address_space(3)))
typedef unsigned short bf16_t;
typedef short bf16x8 __attribute__((ext_vector_type(8)));
typedef float f32x4 __attribute__((ext_vector_type(4)));
typedef unsigned u32x4 __attribute__((ext_vector_type(4)));
constexpr int BM = 256, BK = 64, HALF = 128, HTB = HALF * BK * 2  , STAGE_BYTES = 8 * HTB, NXCD = 8, WGM = 8;

__host__ __device__ __forceinline__ int lds_byte(int r, int c) { const int st = (r >> 4) * 2 + (c >> 5), rr = r & 15, cc = c & 31, ob = rr * 64 + cc * 2; return st * 1024 + (ob ^ (((ob >> 9) & 1) << 5)); }
__host__ __device__ __forceinline__ void stage_rc(int b, int& R, int& C) { const int st = b / 1024, sb = b % 1024, swz = sb ^ (((sb >> 9) & 1) << 5); R = (st >> 1) * 16 + swz / 64; C = (st & 1) * 32 + (swz % 64) / 2; }
__host__ __device__ __forceinline__ int perm32(int rho) { const int n = rho >> 4, i = rho & 15; return 8 * (i >> 2) + 4 * n + (i & 3); }

struct Unit { int pm, pn; };
struct Gemm { const bf16_t* A; const bf16_t* Bt; int M, N, K, lda, ldb, a_pn_off; };

struct StaticOrder {
    int nM, nN, nwg, G, c;
    __host__ __device__ void init(int M, int N, int G_, int c_) { nM = M / BM; nN = N / BM; nwg = nM * nN; G = G_; c = c_; }
    __host__ __device__ bool next(int i, Unit& u) const {
        const long L = (long)i * G + c; if (L >= nwg) return false;
        int wgid = (int)L; { const int q = nwg / NXCD, r = nwg % NXCD, xcd = wgid % NXCD, off = wgid / NXCD; wgid = (xcd < r ? xcd * (q + 1) : r * (q + 1) + (xcd - r) * q) + off; }
        const int nig = WGM * nN, gid = wgid / nig, fm = gid * WGM, gsz = (nM - fm) < WGM ? (nM - fm) : WGM;
        u.pm = fm + ((wgid % nig) % gsz); u.pn = (wgid % nig) / gsz; return true;
    }
};

__device__ __forceinline__ unsigned cvt_pk_bf16(float lo, float hi) { unsigned r; asm volatile("v_cvt_pk_bf16_f32 %0, %1, %2" : "=v"(r) : "v"(lo), "v"(hi)); return r; }
__device__ __forceinline__ float bf_lo(unsigned u) { return __uint_as_float(u << 16); }
__device__ __forceinline__ float bf_hi(unsigned u) { return __uint_as_float(u & 0xffff0000u); }
__device__ __forceinline__ float sigmoidf_(float v) { return 1.0f / (1.0f + __expf(-v)); }

constexpr int OVL_TPB = 34;
struct EpiStore {
    static constexpr bool PERM = true;
    bf16_t* O; int ldc; int split_cols; size_t split_stride; int sig_from;
    __device__ __forceinline__ void operator()(const f32x4 (&acc)[2][2][4][2], const Unit& u, int wr, int wc, int fr, int fq) const {
        const int row0 = u.pm * BM + wr * 64 + fr; int colt = u.pn * BM; bf16_t* base = O; bool sig = false;
        if (split_cols) { const int t = colt / split_cols; base += (size_t)t * split_stride; colt -= t * split_cols; sig = t >= sig_from; }
        const int col0 = colt + wc * 32 + 8 * fq;
#pragma unroll
        for (int ai = 0; ai < 2; ++ai)
#pragma unroll
            for (int m = 0; m < 4; ++m) { bf16_t* rowp = base + (size_t)(row0 + ai * HALF + m * 16) * ldc + col0;
#pragma unroll
                for (int bj = 0; bj < 2; ++bj) { f32x4 v0 = acc[ai][bj][m][0], v1 = acc[ai][bj][m][1];
                    if (sig) {
#pragma unroll
                        for (int e = 0; e < 4; ++e) { v0[e] = sigmoidf_(v0[e]); v1[e] = sigmoidf_(v1[e]); } }
                    u32x4 w; w.x = cvt_pk_bf16(v0[0], v0[1]); w.y = cvt_pk_bf16(v0[2], v0[3]); w.z = cvt_pk_bf16(v1[0], v1[1]); w.w = cvt_pk_bf16(v1[2], v1[3]);
                    *(u32x4*)(rowp + bj * HALF) = w; } }
    }
};
struct EpiMerge {
    static constexpr bool PERM = true;
    bf16_t* O; const bf16_t* YA; const bf16_t* SA; const bf16_t* SB; const float* ps; int ldc;
    __device__ __forceinline__ void operator()(const f32x4 (&acc)[2][2][4][2], const Unit& u, int wr, int wc, int fr, int fq) const {
        const int row0 = u.pm * BM + wr * 64 + fr; const int col0 = u.pn * BM + wc * 32 + 8 * fq;
#pragma unroll
        for (int bj = 0; bj < 2; ++bj) {
            const f32x4 p0 = *(const f32x4*)(ps + col0 + bj * HALF), p1 = *(const f32x4*)(ps + col0 + bj * HALF + 4);
#pragma unroll
            for (int ai = 0; ai < 2; ++ai)
#pragma unroll
                for (int m = 0; m < 4; ++m) { const size_t off = (size_t)(row0 + ai * HALF + m * 16) * ldc + col0 + bj * HALF;
                    const u32x4 ya = *(const u32x4*)(YA + off), sa = *(const u32x4*)(SA + off), sb = *(const u32x4*)(SB + off);
                    const f32x4 v0 = acc[ai][bj][m][0], v1 = acc[ai][bj][m][1];
                    float r[8];
                    r[0] = bf_lo(sa.x) * bf_lo(ya.x) * p0[0] + bf_lo(sb.x) * v0[0]; r[1] = bf_hi(sa.x) * bf_hi(ya.x) * p0[1] + bf_hi(sb.x) * v0[1];
                    r[2] = bf_lo(sa.y) * bf_lo(ya.y) * p0[2] + bf_lo(sb.y) * v0[2]; r[3] = bf_hi(sa.y) * bf_hi(ya.y) * p0[3] + bf_hi(sb.y) * v0[3];
                    r[4] = bf_lo(sa.z) * bf_lo(ya.z) * p1[0] + bf_lo(sb.z) * v1[0]; r[5] = bf_hi(sa.z) * bf_hi(ya.z) * p1[1] + bf_hi(sb.z) * v1[1];
                    r[6] = bf_lo(sa.w) * bf_lo(ya.w) * p1[2] + bf_lo(sb.w) * v1[2]; r[7] = bf_hi(sa.w) * bf_hi(ya.w) * p1[3] + bf_hi(sb.w) * v1[3];
                    u32x4 w; w.x = cvt_pk_bf16(r[0], r[1]); w.y = cvt_pk_bf16(r[2], r[3]); w.z = cvt_pk_bf16(r[4], r[5]); w.w = cvt_pk_bf16(r[6], r[7]);
                    *(u32x4*)(O + off) = w; }
        }
    }
};


__device__ __forceinline__ float dpp_ror1(float v) { return __int_as_float(__builtin_amdgcn_update_dpp(0, __float_as_int(v), 0x121, 0xf, 0xf, false)); }
__device__ __forceinline__ float dpp_ror2(float v) { return __int_as_float(__builtin_amdgcn_update_dpp(0, __float_as_int(v), 0x122, 0xf, 0xf, false)); }
__device__ __forceinline__ float gelu_tanh_(float v) { const float u = 0.7978845608028654f * (v + 0.044715f * v * v * v); return v / (1.0f + __expf(-2.0f * u)); }
struct EpiFfn {
    static constexpr bool PERM = true;
    bf16_t* FFA; const float* cw; const float* cb; int dff;
    __device__ __forceinline__ void operator()(const f32x4 (&acc)[2][2][4][2], const Unit& u, int wr, int wc, int fr, int fq) const {
        const int b = u.pm / OVL_TPB, pml = u.pm % OVL_TPB, nup = 2 * dff;
        const int ch0 = u.pn * 128 + wc * 32 + 8 * fq;
        const bool zero_halo = (pml == 0) && (wr == 0) && (fr < 2);
#pragma unroll
        for (int n = 0; n < 2; ++n) {
            const int ch = ch0 + 4 * n;
            const f32x4 gw0 = *(const f32x4*)(cw + ch), gw1 = *(const f32x4*)(cw + nup + ch), gw2 = *(const f32x4*)(cw + 2 * nup + ch), gb = *(const f32x4*)(cb + ch);
            const f32x4 vw0 = *(const f32x4*)(cw + dff + ch), vw1 = *(const f32x4*)(cw + nup + dff + ch), vw2 = *(const f32x4*)(cw + 2 * nup + dff + ch), vb = *(const f32x4*)(cb + dff + ch);
#pragma unroll
            for (int ai = 0; ai < 2; ++ai) {
                float pg1[4] = {0.f, 0.f, 0.f, 0.f}, pg2[4] = {0.f, 0.f, 0.f, 0.f}, pv1[4] = {0.f, 0.f, 0.f, 0.f}, pv2[4] = {0.f, 0.f, 0.f, 0.f};
#pragma unroll
                for (int m = 0; m < 4; ++m) {
                    const int t = 248 * pml + 62 * (2 * ai + wr) + 16 * m + fr - 2;
                    float r[4];
#pragma unroll
                    for (int i = 0; i < 4; ++i) {
                        float gv = acc[ai][0][m][n][i], vv = acc[ai][1][m][n][i];
                        if (ai == 0 && m == 0) { gv = zero_halo ? 0.f : gv; vv = zero_halo ? 0.f : vv; }
                        const float g1 = dpp_ror1(gv), g2 = dpp_ror2(gv), v1 = dpp_ror1(vv), v2 = dpp_ror2(vv);
                        const float qg1 = fr >= 1 ? g1 : pg1[i], qg2 = fr >= 2 ? g2 : pg2[i], qv1 = fr >= 1 ? v1 : pv1[i], qv2 = fr >= 2 ? v2 : pv2[i];
                        const float cgv = gb[i] + gw0[i] * qg2 + gw1[i] * qg1 + gw2[i] * gv, cvv = vb[i] + vw0[i] * qv2 + vw1[i] * qv1 + vw2[i] * vv;
                        r[i] = gelu_tanh_(cgv) * cvv;
                        pg1[i] = g1; pg2[i] = g2; pv1[i] = v1; pv2[i] = v2;
                    }
                    if ((m > 0 || fr >= 2) && t < 8192) {
                        unsigned long long w = (unsigned long long)cvt_pk_bf16(r[0], r[1]) | ((unsigned long long)cvt_pk_bf16(r[2], r[3]) << 32);
                        *(unsigned long long*)(FFA + (size_t)(b * 8192 + t) * dff + ch) = w; }
                }
            }
        }
    }
};

template <class Epi, class Sched, bool ALIGN_EPI = false, bool OVL = false>
__device__ __forceinline__ void gemm_phase(PG8_LAS unsigned char* lds, const Gemm g, const Sched& S, const Epi& E) {
    const int tid = threadIdx.x, wid = __builtin_amdgcn_readfirstlane(tid >> 6), lane = tid & 63, wr = wid >> 2, wc = wid & 3, fr = lane & 15, fq = lane >> 4;
    const int K = g.K, nt = K / BK;
    unsigned voffA[2], voffB[2];
#pragma unroll
    for (int i = 0; i < 2; ++i) { int R, C; stage_rc(tid * 16 + i * 8192, R, C); const int Rb = Epi::PERM ? ((R & ~31) + perm32(R & 31)) : R;
        const int Ra = OVL ? 62 * (R >> 6) + (R & 63) : R;
        voffA[i] = (unsigned)(Ra * g.lda + C) * 2u; voffB[i] = (unsigned)(Rb * g.ldb + C) * 2u; }
    const size_t kstep = (size_t)(BK * 2);
    const size_t hstepA = (size_t)(OVL ? 124 : HALF) * g.lda * 2, hstepB = (size_t)HALF * g.ldb * 2;
    const size_t tstepA = 2 * hstepA, tstepB = 2 * hstepB;
    const size_t pnoffA = (size_t)g.a_pn_off * 2;
#define PG8_TILEA(u) ((const char*)g.A + (OVL ? ((long)(((u).pm / OVL_TPB) * 8192 + 248 * ((u).pm % OVL_TPB) - 2) * (long)g.lda * 2) : (long)((size_t)(u).pm * tstepA)) + (size_t)(u).pn * pnoffA)
    const unsigned ldsw = (unsigned)wid * 1024u;
    const int aoff = lds_byte(wr * 64 + fr, fq * 8), boff = lds_byte(wc * 32 + fr, fq * 8);
#define PG8_SA(b, h) (((b) * 2 + (h)) * HTB)
#define PG8_SB(b, h) ((4 + (b) * 2 + (h)) * HTB)
#define PG8_STAGE(bufoff, gbase, voff) do { _Pragma("unroll") for (int _i = 0; _i < 2; ++_i) \
        __builtin_amdgcn_global_load_lds((const unsigned*)((const char*)(gbase) + (voff)[_i]), (PG8_LAS unsigned*)(lds + (bufoff) + ldsw + _i * 8192), 16, 0, 0); } while (0)
#define PG8_LDA(dst, b, h) do { _Pragma("unroll") for (int m = 0; m < 4; ++m) _Pragma("unroll") for (int k = 0; k < 2; ++k) dst[m][k] = *(const PG8_LAS bf16x8*)(lds + PG8_SA(b, h) + aoff + m * 2048 + k * 1024); } while (0)
#define PG8_LDB(dst, b, h) do { _Pragma("unroll") for (int n = 0; n < 2; ++n) _Pragma("unroll") for (int k = 0; k < 2; ++k) dst[n][k] = *(const PG8_LAS bf16x8*)(lds + PG8_SB(b, h) + boff + n * 2048 + k * 1024); } while (0)
#define PG8_MMA(ai, bj, At, Bt) do { __builtin_amdgcn_s_setprio(1); _Pragma("unroll") for (int m = 0; m < 4; ++m) _Pragma("unroll") for (int n = 0; n < 2; ++n) _Pragma("unroll") for (int k = 0; k < 2; ++k) \
        acc[ai][bj][m][n] = __builtin_amdgcn_mfma_f32_16x16x32_bf16(Bt[n][k], At[m][k], acc[ai][bj][m][n], 0, 0, 0); __builtin_amdgcn_s_setprio(0); } while (0)
#define PG8_WAIT_V(n) asm volatile("s_waitcnt vmcnt(" #n ")" ::: "memory")
#define PG8_WAIT_L(n) asm volatile("s_waitcnt lgkmcnt(" #n ")" ::: "memory")
#define PG8_BAR __builtin_amdgcn_s_barrier()
#define PG8_SCHED __builtin_amdgcn_sched_barrier(0)
    Unit cur, nxt; int ui = 0;
    if (!S.next(0, cur)) return;
    f32x4 acc[2][2][4][2];
#pragma unroll
    for (int a = 0; a < 2; ++a)
#pragma unroll
        for (int b = 0; b < 2; ++b)
#pragma unroll
            for (int m = 0; m < 4; ++m)
#pragma unroll
                for (int n = 0; n < 2; ++n) acc[a][b][m][n] = (f32x4){0.f, 0.f, 0.f, 0.f};
    bf16x8 At[4][2], B0[2][2], B1[2][2];
    const char* cA = PG8_TILEA(cur); const char* cB = (const char*)g.Bt + (size_t)cur.pn * tstepB;
    PG8_STAGE(PG8_SB(0, 0), cB, voffB); PG8_STAGE(PG8_SB(0, 1), cB + hstepB, voffB); PG8_STAGE(PG8_SA(0, 0), cA, voffA); PG8_STAGE(PG8_SA(0, 1), cA + hstepA, voffA);
    if (wr == 1) PG8_BAR;
    PG8_WAIT_V(2); PG8_BAR;
    PG8_STAGE(PG8_SB(1, 0), cB + kstep, voffB); PG8_STAGE(PG8_SA(1, 0), cA + kstep, voffA); PG8_STAGE(PG8_SB(1, 1), cB + hstepB + kstep, voffB);
    PG8_WAIT_V(6); PG8_BAR;
    for (;;) {
        const bool has_next = S.next(ui + 1, nxt);
        const char* nA = has_next ? PG8_TILEA(nxt) : cA; const char* nB = has_next ? (const char*)g.Bt + (size_t)nxt.pn * tstepB : cB;
        for (int t = 0; t < nt; t += 2) {
            const bool last = (t == nt - 2);
            const char* a1 = cA + (size_t)(t + 1) * kstep;
            const char* a2 = last ? nA : cA + (size_t)(t + 2) * kstep; const char* b2 = last ? nB : cB + (size_t)(t + 2) * kstep;
            const char* a3 = a2 + kstep; const char* b3 = b2 + kstep;
            PG8_LDB(B0, 0, 0); PG8_LDB(B1, 0, 1); PG8_SCHED; PG8_LDA(At, 0, 0); PG8_STAGE(PG8_SA(1, 1), a1 + hstepA, voffA);
            PG8_WAIT_V(8); PG8_WAIT_L(0); PG8_BAR; PG8_MMA(0, 0, At, B0); PG8_MMA(0, 1, At, B1); PG8_BAR; PG8_SCHED;
            PG8_LDA(At, 0, 1); PG8_STAGE(PG8_SB(0, 0), b2, voffB); PG8_STAGE(PG8_SB(0, 1), b2 + hstepB, voffB); PG8_STAGE(PG8_SA(0, 0), a2, voffA);
            PG8_WAIT_V(8); PG8_WAIT_L(0); PG8_BAR; PG8_MMA(1, 0, At, B0); PG8_MMA(1, 1, At, B1); PG8_BAR; PG8_SCHED;
            PG8_LDB(B0, 1, 0); PG8_LDB(B1, 1, 1); PG8_SCHED; PG8_LDA(At, 1, 0); PG8_STAGE(PG8_SA(0, 1), a2 + hstepA, voffA);
            PG8_WAIT_V(8); PG8_WAIT_L(0); PG8_BAR; PG8_MMA(0, 0, At, B0); PG8_MMA(0, 1, At, B1); PG8_BAR; PG8_SCHED;
            PG8_LDA(At, 1, 1); PG8_STAGE(PG8_SB(1, 0), b3, voffB); PG8_STAGE(PG8_SB(1, 1), b3 + hstepB, voffB); PG8_STAGE(PG8_SA(1, 0), a3, voffA);
            PG8_WAIT_V(8); PG8_WAIT_L(0); PG8_BAR; PG8_MMA(1, 0, At, B0); PG8_MMA(1, 1, At, B1); PG8_BAR; PG8_SCHED;
        }
        if constexpr (ALIGN_EPI) { if (wr == 0) PG8_BAR; }
        E(acc, cur, wr, wc, fr, fq);
        if (!has_next) break;
#pragma unroll
        for (int a = 0; a < 2; ++a)
#pragma unroll
            for (int b = 0; b < 2; ++b)
#pragma unroll
                for (int m = 0; m < 4; ++m)
#pragma unroll
                    for (int n = 0; n < 2; ++n) acc[a][b][m][n] = (f32x4){0.f, 0.f, 0.f, 0.f};
        cur = nxt; cA = nA; cB = nB; ++ui;
        if constexpr (ALIGN_EPI) { if (wr == 1) PG8_BAR; }
    }
    PG8_WAIT_V(0);
    if constexpr (!ALIGN_EPI) { if (wr == 0) PG8_BAR; }
    PG8_BAR;
#undef PG8_TILEA
#undef PG8_SA
#undef PG8_SB
#undef PG8_STAGE
#undef PG8_LDA
#undef PG8_LDB
#undef PG8_MMA
#undef PG8_WAIT_V
#undef PG8_WAIT_L
#undef PG8_BAR
#undef PG8_SCHED
}
}

constexpr int NWAVES = 8, NTHR = NWAVES * 64;
constexpr int BATCH = 2, SEQ = 8192, D = 1024, M = BATCH * SEQ, DIN = 6 * D, DFF = 2816, NUP = 2 * DFF, NMOD = 6 * D;
constexpr float EPS = 1e-6f;
constexpr size_t MiB = 1u << 20;
constexpr size_t WS_MOD = 0, WS_BAR = 49152, CTL_ZERO_BYTES = 65536;
constexpr size_t WS_WIN = 1 * MiB, WS_WPOOL = 13 * MiB, WS_WBOUT = 14 * MiB, WS_WO = 16 * MiB, WS_WUP = 18 * MiB, WS_WDOWN = 29 * MiB;
constexpr size_t WS_SLOT0 = 35 * MiB, SLOT_BYTES = 32 * MiB;
constexpr size_t WS_FFA = WS_SLOT0 + 4 * SLOT_BYTES;
constexpr size_t WS_END = 256 * MiB;
static_assert(WS_FFA + (size_t)M * DFF * 2 <= WS_END, "ws map");
constexpr int RING_BYTES = 131072, LDS_BYTES = 147456;

#define LAS __attribute__((address_space(3)))
typedef unsigned short bf16;
typedef unsigned v4u __attribute__((ext_vector_type(4)));
typedef unsigned v2u __attribute__((ext_vector_type(2)));
typedef float f32x4 __attribute__((ext_vector_type(4)));
#define LDS_WAIT() asm volatile("s_waitcnt lgkmcnt(0)" ::: "memory")
__device__ __forceinline__ unsigned f2bf(float f) { unsigned u = __builtin_bit_cast(unsigned, f); return (u + 0x7fffu + ((u >> 16) & 1u)) >> 16; }
__device__ __forceinline__ unsigned pk2(float lo, float hi) { return f2bf(lo) | (f2bf(hi) << 16); }
__device__ __forceinline__ float blo(unsigned u) { return __uint_as_float(u << 16); }
__device__ __forceinline__ float bhi(unsigned u) { return __uint_as_float(u & 0xffff0000u); }
__device__ __forceinline__ void unpack8(const v4u u, float (&f)[8]) { f[0] = blo(u.x); f[1] = bhi(u.x); f[2] = blo(u.y); f[3] = bhi(u.y); f[4] = blo(u.z); f[5] = bhi(u.z); f[6] = blo(u.w); f[7] = bhi(u.w); }
__device__ __forceinline__ v4u pack8(const float (&f)[8]) { v4u o; o.x = pk2(f[0], f[1]); o.y = pk2(f[2], f[3]); o.z = pk2(f[4], f[5]); o.w = pk2(f[6], f[7]); return o; }
__device__ __forceinline__ float wave_sum(float v) {
#pragma unroll
    for (int o = 1; o < 64; o <<= 1) v += __shfl_xor(v, o);
    return v;
}
__device__ __forceinline__ float gelu_tanh(float v) { const float u = 0.7978845608028654f * (v + 0.044715f * v * v * v); return v / (1.0f + __expf(-2.0f * u)); }

template <bool UPMAP = false>
__device__ __forceinline__ void p0_transpose_item(const float* W, int K, int N, bf16* WT, LAS float* scr, int item, int lane) {
    const int nblk = N / 32, kb = item / nblk, nb = item % nblk, k0 = 64 * kb, n0 = 32 * nb;
    const int d0 = UPMAP ? (256 * ((n0 % 2816) / 128) + 128 * (n0 / 2816) + (n0 % 128)) : n0;
#pragma unroll 8
    for (int i = 0; i < 32; ++i) { const int kk = 2 * i + (lane >> 5); scr[kk * 33 + (lane & 31)] = W[(size_t)(k0 + kk) * N + n0 + (lane & 31)]; }
    LDS_WAIT(); asm volatile("" ::: "memory");
    const int c = lane & 7;
#pragma unroll
    for (int j = 0; j < 4; ++j) { const int n = (lane >> 3) + 8 * j; const LAS float* s = scr + (8 * c) * 33 + n;
        v4u o; o.x = pk2(s[0 * 33], s[1 * 33]); o.y = pk2(s[2 * 33], s[3 * 33]); o.z = pk2(s[4 * 33], s[5 * 33]); o.w = pk2(s[6 * 33], s[7 * 33]);
        *(v4u*)(WT + (size_t)(d0 + n) * K + k0 + 8 * c) = o; }
    LDS_WAIT(); asm volatile("" ::: "memory");
}

#define XB_TMO      128
#define XB_XCNT(j)  (256  + 64 * (j))
#define XB_XSUB(j)  (1280 + 64 * (j))
#define XB_XGEN(j)  (2304 + 64 * (j))
#define XB_TOP      3328
#define XB_TOPGEN   3392
#define XCD_BAR_WORDS 3456
#define XB_SPIN_CAP (1u << 18)

__device__ __forceinline__ unsigned xb_ld(unsigned* p)              { return __hip_atomic_load(p, __ATOMIC_RELAXED, __HIP_MEMORY_SCOPE_AGENT); }
__device__ __forceinline__ unsigned xb_add(unsigned* p, unsigned v) { return __hip_atomic_fetch_add(p, v, __ATOMIC_RELAXED, __HIP_MEMORY_SCOPE_AGENT); }
__device__ __forceinline__ unsigned xb_xcc_id() { return (unsigned)__builtin_amdgcn_s_getreg((3 << 11) | 20) & 0xFu; }
#define XB_SPIN(cond, bar) do { unsigned _sp = 0; while (cond) { __builtin_amdgcn_s_sleep(1); \
    if ((++_sp & 255u) == 0u) { if (xb_ld(&(bar)[XB_TMO])) break; if (_sp > XB_SPIN_CAP) { atomicAdd(&(bar)[XB_TMO], 1u); break; } } } } while (0)

struct XcdBarrier {
    unsigned* bar; unsigned x;
    volatile LAS unsigned* st;
};

__device__ __forceinline__ XcdBarrier xcd_barrier_post(unsigned* bar, volatile LAS unsigned* st) {
    XcdBarrier b; b.bar = bar; b.x = xb_xcc_id(); b.st = st;
    if (threadIdx.x == 0) (void)xb_add(&bar[XB_XCNT(b.x)], 1u);
    return b;
}
__device__ __forceinline__ void xcd_barrier_complete(unsigned* bar, unsigned x, unsigned& nloc, unsigned& nx) {
    const unsigned G = gridDim.x * gridDim.y * gridDim.z;
    unsigned sum, cnt, mine, sp = 0u;
    for (;;) {
        sum = 0u; cnt = 0u; mine = 0u;
#pragma unroll
        for (unsigned j = 0; j < 16; ++j) { const unsigned c = xb_ld(&bar[XB_XCNT(j)]); sum += c; cnt += (c > 0u) ? 1u : 0u; mine = (j == x) ? c : mine; }
        if (sum == G) break;
        __builtin_amdgcn_s_sleep(1);
        if ((++sp & 255u) == 0u) { if (xb_ld(&bar[XB_TMO])) break; if (sp > XB_SPIN_CAP) { atomicAdd(&bar[XB_TMO], 1u); break; } }
    }
    nloc = mine > 0u ? mine : 1u; nx = cnt > 0u ? cnt : 1u;
}

__device__ __forceinline__ void xcd_barrier(const XcdBarrier& b) {
    asm volatile("s_waitcnt vmcnt(0)" ::: "memory");
    __syncthreads();
    if (threadIdx.x == 0) {
        unsigned* bar = b.bar;
        __builtin_amdgcn_s_waitcnt(0);
        unsigned nloc = b.st[0], nx = b.st[1];
        if (nloc == 0u) { xcd_barrier_complete(bar, b.x, nloc, nx); b.st[0] = nloc; b.st[1] = nx; }
        const unsigned old = xb_add(&bar[XB_XSUB(b.x)], 1u);
        const unsigned gen = old / nloc;
        if (old + 1u == (gen + 1u) * nloc) {
            __builtin_amdgcn_fence(__ATOMIC_RELEASE, "agent");
            asm volatile("s_waitcnt vmcnt(0)" ::: "memory");
            const unsigned og = xb_add(&bar[XB_TOP], 1u);
            const unsigned tg = og / nx;
            if (og + 1u == (tg + 1u) * nx) xb_add(&bar[XB_TOPGEN], 1u);
            else XB_SPIN(xb_ld(&bar[XB_TOPGEN]) == tg, bar);
            __builtin_amdgcn_fence(__ATOMIC_ACQUIRE, "agent");
            xb_add(&bar[XB_XGEN(b.x)], 1u);
            asm volatile("s_waitcnt vmcnt(0)" ::: "memory");
        } else {
            XB_SPIN(xb_ld(&bar[XB_XGEN(b.x)]) == gen, bar);
            __builtin_amdgcn_fence(__ATOMIC_ACQUIRE, "agent");
            asm volatile("s_waitcnt vmcnt(0)" ::: "memory");
        }
    }
    __syncthreads();
}

struct Args { const float* in[19]; float* out; unsigned char* ws; };

__global__ void __launch_bounds__(NTHR, 2) fwd_megakernel(Args args) {
    extern __shared__ __attribute__((aligned(16))) unsigned char lds_raw[];
    cg::grid_group grid = cg::this_grid();
    LAS unsigned char* lds = (LAS unsigned char*)lds_raw;
    const int tid = threadIdx.x, lane = tid & 63, wave = __builtin_amdgcn_readfirstlane(tid >> 6);
    const int G = gridDim.x, bx = blockIdx.x;
    const int gw = bx * NWAVES + wave, NGW = G * NWAVES;
    unsigned char* ws = args.ws;
    const float* x = args.in[0]; const float* cvec = args.in[1];
    const float *g_pre_mix = args.in[2], *g_post_mix = args.in[3], *g_pre_ffn = args.in[4], *g_post_ffn = args.in[5];
    const float *w_ada = args.in[6], *b_ada = args.in[7], *w_in = args.in[8], *w_pool = args.in[9], *pool_scale = args.in[10];
    const float *conv_w = args.in[11], *conv_b = args.in[12], *w_bout = args.in[13], *w_o = args.in[14], *w_up = args.in[15];
    const float *ffn_conv_w = args.in[16], *ffn_conv_b = args.in[17], *w_down = args.in[18];
    float* out = args.out;
    float* mod = (float*)(ws + WS_MOD);
    volatile LAS unsigned* MISC = (volatile LAS unsigned*)(lds + RING_BYTES + 320);
    if (tid < 32) MISC[tid] = 0u;
    __syncthreads();
    XcdBarrier xbar = xcd_barrier_post((unsigned*)(ws + WS_BAR), MISC + 8);
    if (G == 0x7fffffff) grid.sync();
#define GRID_BAR() xcd_barrier(xbar)
    bf16 *WT_IN = (bf16*)(ws + WS_WIN), *WT_POOL = (bf16*)(ws + WS_WPOOL), *WT_BOUT = (bf16*)(ws + WS_WBOUT), *WT_O = (bf16*)(ws + WS_WO), *WT_UP = (bf16*)(ws + WS_WUP), *WT_DOWN = (bf16*)(ws + WS_WDOWN);
    bf16* SLOT[6];
#pragma unroll
    for (int i = 0; i < 6; ++i) SLOT[i] = (bf16*)(ws + WS_SLOT0 + i * SLOT_BYTES);
    bf16* H1 = (bf16*)out;
    bf16* BMIX = (bf16*)out; bf16* POOLED = (bf16*)out + (size_t)M * D;
    bf16* YA = SLOT[0]; bf16* MERGED = SLOT[1]; bf16* OB = SLOT[2]; bf16* H2 = SLOT[3];
    bf16* FFA = (bf16*)(ws + WS_FFA); bf16* FFO = SLOT[0];

    {
        LAS float* scr = (LAS float*)(lds + wave * 16384);
        constexpr int I_IN = (D / 64) * (DIN / 32), I_POOL = (256 / 64) * (256 / 32), I_SQ = (D / 64) * (D / 32), I_UP = (D / 64) * (NUP / 32), I_DOWN = (DFF / 64) * (D / 32);
        constexpr int NITEMS = I_IN + 4 * I_POOL + 2 * I_SQ + I_UP + I_DOWN;
        for (int it = gw; it < NITEMS; it += NGW) {
            int r = it;
            if (r < I_IN) { p0_transpose_item(w_in, D, DIN, WT_IN, scr, r, lane); continue; } r -= I_IN;
            if (r < 4 * I_POOL) { const int gq = r / I_POOL; p0_transpose_item(w_pool + gq * 65536, 256, 256, WT_POOL + gq * 65536, scr, r % I_POOL, lane); continue; } r -= 4 * I_POOL;
            if (r < I_SQ) { p0_transpose_item(w_bout, D, D, WT_BOUT, scr, r, lane); continue; } r -= I_SQ;
            if (r < I_SQ) { p0_transpose_item(w_o, D, D, WT_O, scr, r, lane); continue; } r -= I_SQ;
            if (r < I_UP) { p0_transpose_item<true>(w_up, D, NUP, WT_UP, scr, r, lane); continue; } r -= I_UP;
            p0_transpose_item(w_down, DFF, D, WT_DOWN, scr, r, lane);
        }
        for (int it = gw; it < 24 * 32; it += NGW) {
            const int cgp = it % 24, ks = it / 24, n0 = cgp * 256 + lane * 4, k0 = ks * 32;
            f32x4 a0 = (f32x4){0.f, 0.f, 0.f, 0.f}, a1 = a0;
            if (ks == 0) { a0 = *(const f32x4*)(b_ada + n0); a1 = a0; }
#pragma unroll 8
            for (int k = 0; k < 32; ++k) { const f32x4 w = *(const f32x4*)(w_ada + (size_t)(k0 + k) * NMOD + n0); const float c0 = cvec[k0 + k], c1 = cvec[D + k0 + k]; a0 += w * c0; a1 += w * c1; }
#pragma unroll
            for (int e = 0; e < 4; ++e) { atomicAdd(mod + n0 + e, a0[e]); atomicAdd(mod + NMOD + n0 + e, a1[e]); }
        }
    }
    GRID_BAR();

    for (int m = gw; m < M; m += NGW) {
        const int b = m >> 13; const float* mb = mod + b * NMOD;
        const f32x4* xr = (const f32x4*)(x + (size_t)m * D) + lane;
        f32x4 v[4]; float s = 0.f;
#pragma unroll
        for (int j = 0; j < 4; ++j) { v[j] = xr[64 * j]; s += (v[j].x * v[j].x + v[j].y * v[j].y) + (v[j].z * v[j].z + v[j].w * v[j].w); }
        const float rstd = rsqrtf(wave_sum(s) * (1.f / D) + EPS);
        unsigned long long* o8 = (unsigned long long*)(H1 + (size_t)m * D) + lane;
#pragma unroll
        for (int j = 0; j < 4; ++j) { const int col = 4 * lane + 256 * j;
            const f32x4 gg = *(const f32x4*)(g_pre_mix + col), sh = *(const f32x4*)(mb + col), sc = *(const f32x4*)(mb + D + col);
            const f32x4 h = v[j] * rstd * gg * (sc + 1.0f) + sh;
            o8[64 * j] = (unsigned long long)pk2(h.x, h.y) | ((unsigned long long)pk2(h.z, h.w) << 32); }
    }
    GRID_BAR();

    {
        pg8::Gemm g{H1, WT_IN, M, DIN, D, D, D, 0}; pg8::StaticOrder S; S.init(M, DIN, G, bx);
        pg8::EpiStore E{SLOT[0], D, D, (size_t)SLOT_BYTES / 2, 4};
        pg8::gemm_phase<pg8::EpiStore, pg8::StaticOrder, true>(lds, g, S, E);
    }
    GRID_BAR();

    for (int ch = bx; ch < M / 64; ch += G) {
        const int co = tid & 127, rs = tid >> 7, c0 = co * 8;
        const int row0 = ch * 64 + rs * 16, t0 = row0 & (SEQ - 1);
        const bf16 *UPp = SLOT[0], *UX = SLOT[1], *UB = SLOT[2], *UC = SLOT[3];
        float w0[8], w1[8], w2[8], cb[8];
#pragma unroll
        for (int e = 0; e < 8; ++e) { w0[e] = conv_w[c0 + e]; w1[e] = conv_w[D + c0 + e]; w2[e] = conv_w[2 * D + c0 + e]; cb[e] = conv_b[c0 + e]; }
        float p2[8], p1[8];
#pragma unroll
        for (int e = 0; e < 8; ++e) { p2[e] = 0.f; p1[e] = 0.f; }
        if (t0 >= 2) { float a[8], b[8]; unpack8(*(const v4u*)(UC + (size_t)(row0 - 2) * D + c0), a); unpack8(*(const v4u*)(UX + (size_t)(row0 - 2) * D + c0), b);
#pragma unroll
            for (int e = 0; e < 8; ++e) p2[e] = a[e] * b[e]; }
        if (t0 >= 1) { float a[8], b[8]; unpack8(*(const v4u*)(UC + (size_t)(row0 - 1) * D + c0), a); unpack8(*(const v4u*)(UX + (size_t)(row0 - 1) * D + c0), b);
#pragma unroll
            for (int e = 0; e < 8; ++e) p1[e] = a[e] * b[e]; }
        const int win = 2 << (co >> 5);
        float sum[8];
#pragma unroll
        for (int e = 0; e < 8; ++e) sum[e] = 0.f;
        for (int j = 1; j < win; ++j) { if (t0 - j >= 0) { float a[8]; unpack8(*(const v4u*)(UPp + (size_t)(row0 - j) * D + c0), a);
#pragma unroll
            for (int e = 0; e < 8; ++e) sum[e] += a[e]; } }
#pragma unroll 2
        for (int i = 0; i < 16; ++i) {
            const size_t off = (size_t)(row0 + i) * D + c0; const int t = t0 + i;
            float ux[8], uc[8], ub[8], up[8], r[8];
            unpack8(*(const v4u*)(UX + off), ux); unpack8(*(const v4u*)(UC + off), uc); unpack8(*(const v4u*)(UB + off), ub); unpack8(*(const v4u*)(UPp + off), up);
#pragma unroll
            for (int e = 0; e < 8; ++e) { const float cur = uc[e] * ux[e]; r[e] = ub[e] * (cb[e] + w0[e] * p2[e] + w1[e] * p1[e] + w2[e] * cur); p2[e] = p1[e]; p1[e] = cur; }
            *(v4u*)(BMIX + off) = pack8(r);
            const float inv = 1.0f / (float)((t + 1) < win ? (t + 1) : win);
#pragma unroll
            for (int e = 0; e < 8; ++e) { sum[e] += up[e]; r[e] = sum[e] * inv - up[e]; }
            *(v4u*)(POOLED + off) = pack8(r);
            if (t - win + 1 >= 0) { float a[8]; unpack8(*(const v4u*)(UPp + (size_t)(row0 + i - win + 1) * D + c0), a);
#pragma unroll
                for (int e = 0; e < 8; ++e) sum[e] -= a[e]; }
        }
    }
    GRID_BAR();

    {
        pg8::Gemm g{POOLED, WT_POOL, M, D, 256, D, 256, 256}; pg8::StaticOrder S; S.init(M, D, G, bx);
        pg8::EpiStore E{YA, D, 0, 0, 0};
        pg8::gemm_phase<pg8::EpiStore, pg8::StaticOrder, true>(lds, g, S, E);
    }
    __threadfence(); __syncthreads();
    {
        pg8::Gemm g{BMIX, WT_BOUT, M, D, D, D, D, 0}; pg8::StaticOrder S; S.init(M, D, G, bx);
        pg8::EpiMerge E{MERGED, YA, SLOT[4], SLOT[5], pool_scale, D};
        pg8::gemm_phase<pg8::EpiMerge, pg8::StaticOrder, true>(lds, g, S, E);
    }
    GRID_BAR();

    {
        pg8::Gemm g{MERGED, WT_O, M, D, D, D, D, 0}; pg8::StaticOrder S; S.init(M, D, G, bx);
        pg8::EpiStore E{OB, D, 0, 0, 0};
        pg8::gemm_phase<pg8::EpiStore, pg8::StaticOrder, true>(lds, g, S, E);
    }
    GRID_BAR();

    for (int m = gw; m < M; m += NGW) {
        const int b = m >> 13; const float* mb = mod + b * NMOD;
        const v2u* orow = (const v2u*)(OB + (size_t)m * D) + lane;
        f32x4 o[4]; float s = 0.f;
#pragma unroll
        for (int j = 0; j < 4; ++j) { const v2u u = orow[64 * j]; o[j] = (f32x4){blo(u.x), bhi(u.x), blo(u.y), bhi(u.y)}; s += (o[j].x * o[j].x + o[j].y * o[j].y) + (o[j].z * o[j].z + o[j].w * o[j].w); }
        const float rstd = rsqrtf(wave_sum(s) * (1.f / D) + EPS);
        const f32x4* xr = (const f32x4*)(x + (size_t)m * D) + lane; f32x4* outr = (f32x4*)(out + (size_t)m * D) + lane;
        float s2 = 0.f;
#pragma unroll
        for (int j = 0; j < 4; ++j) { const int col = 4 * lane + 256 * j;
            const f32x4 gg = *(const f32x4*)(g_post_mix + col), gt = *(const f32x4*)(mb + 2 * D + col);
            o[j] = xr[64 * j] + gt * (o[j] * rstd * gg); outr[64 * j] = o[j];
            s2 += (o[j].x * o[j].x + o[j].y * o[j].y) + (o[j].z * o[j].z + o[j].w * o[j].w); }
        const float rstd2 = rsqrtf(wave_sum(s2) * (1.f / D) + EPS);
        unsigned long long* o8 = (unsigned long long*)(H2 + (size_t)m * D) + lane;
#pragma unroll
        for (int j = 0; j < 4; ++j) { const int col = 4 * lane + 256 * j;
            const f32x4 gg = *(const f32x4*)(g_pre_ffn + col), sh = *(const f32x4*)(mb + 3 * D + col), sc = *(const f32x4*)(mb + 4 * D + col);
            const f32x4 h = o[j] * rstd2 * gg * (sc + 1.0f) + sh;
            o8[64 * j] = (unsigned long long)pk2(h.x, h.y) | ((unsigned long long)pk2(h.z, h.w) << 32); }
    }
    GRID_BAR();

    {
        pg8::Gemm g{H2, WT_UP, 2 * pg8::OVL_TPB * 256, NUP, D, D, D, 0}; pg8::StaticOrder S; S.init(2 * pg8::OVL_TPB * 256, NUP, G, bx);
        pg8::EpiFfn E{FFA, ffn_conv_w, ffn_conv_b, DFF};
        pg8::gemm_phase<pg8::EpiFfn, pg8::StaticOrder, true, true>(lds, g, S, E);
    }
    GRID_BAR();

    {
        pg8::Gemm g{FFA, WT_DOWN, M, D, DFF, DFF, DFF, 0}; pg8::StaticOrder S; S.init(M, D, G, bx);
        pg8::EpiStore E{FFO, D, 0, 0, 0};
        pg8::gemm_phase<pg8::EpiStore, pg8::StaticOrder, true>(lds, g, S, E);
    }
    GRID_BAR();

    for (int m = gw; m < M; m += NGW) {
        const int b = m >> 13; const float* mb = mod + b * NMOD;
        const v2u* orow = (const v2u*)(FFO + (size_t)m * D) + lane;
        f32x4 o[4]; float s = 0.f;
#pragma unroll
        for (int j = 0; j < 4; ++j) { const v2u u = orow[64 * j]; o[j] = (f32x4){blo(u.x), bhi(u.x), blo(u.y), bhi(u.y)}; s += (o[j].x * o[j].x + o[j].y * o[j].y) + (o[j].z * o[j].z + o[j].w * o[j].w); }
        const float rstd = rsqrtf(wave_sum(s) * (1.f / D) + EPS);
        f32x4* outr = (f32x4*)(out + (size_t)m * D) + lane;
#pragma unroll
        for (int j = 0; j < 4; ++j) { const int col = 4 * lane + 256 * j;
            const f32x4 gg = *(const f32x4*)(g_post_ffn + col), gt = *(const f32x4*)(mb + 5 * D + col);
            outr[64 * j] = outr[64 * j] + gt * (o[j] * rstd * gg); }
    }
}

extern "C" void kernel_launch(void* const* d_in, const int* in_sizes, int n_in, void* d_out, int out_size, void* d_ws, size_t ws_size, hipStream_t stream) {
    static int grid = 0;
    if (grid == 0) {
        if (n_in != 19 || out_size != M * D || ws_size < WS_END) { fprintf(stderr, "kernel_launch: unexpected shapes (n_in %d out %d ws %zu)\n", n_in, out_size, ws_size); grid = -1; return; }
        int dev = 0, cus = 0, per_cu = 0;
        hipGetDevice(&dev); hipDeviceGetAttribute(&cus, hipDeviceAttributeMultiprocessorCount, dev);
        if (hipFuncSetAttribute((const void*)fwd_megakernel, hipFuncAttributeMaxDynamicSharedMemorySize, LDS_BYTES) != hipSuccess) { fprintf(stderr, "kernel_launch: hipFuncSetAttribute failed\n"); grid = -1; return; }
        if (hipOccupancyMaxActiveBlocksPerMultiprocessor(&per_cu, (const void*)fwd_megakernel, NTHR, LDS_BYTES) != hipSuccess || per_cu < 1) { fprintf(stderr, "kernel_launch: occupancy query failed (%d)\n", per_cu); (void)hipGetLastError(); per_cu = 1; }
        grid = cus * (per_cu > 1 ? 1 : per_cu);
        fprintf(stderr, "kernel_launch: cus %d per_cu %d grid %d\n", cus, per_cu, grid);
    }
    if (grid < 0) return;
    hipMemsetAsync((char*)d_ws + WS_MOD, 0, CTL_ZERO_BYTES, stream);
    Args a{};
    for (int i = 0; i < 19; ++i) a.in[i] = (const float*)d_in[i];
    a.out = (float*)d_out; a.ws = (unsigned char*)d_ws;
    void* params[] = {&a};
    hipError_t e = hipLaunchCooperativeKernel((const void*)fwd_megakernel, dim3(grid), dim3(NTHR), params, LDS_BYTES, stream);
    if (e != hipSuccess) fprintf(stderr, "cooperative launch failed: %s (grid %d)\n", hipGetErrorString(e), grid);
}
```
